# Optimizing an MI355X kernel written in HIP

```python
import jax, jax.numpy as jnp
from jax import lax
import numpy as np

D_MODEL = 1024
BATCH = 8
SEQ = 2048
DEPTH = 1

CONV_WIDTH = 512
CONV_KERNEL = 3
N_HEADS = 8
HEAD_DIM = 64
ATTN_WIDTH = N_HEADS * HEAD_DIM
MOBA_BLOCK = 256
MOBA_TOPK = 3
QUERY_CHUNK = 32
N_GROUPS = 4
EXPERTS_PER_GROUP = 8
N_EXPERTS = N_GROUPS * EXPERTS_PER_GROUP
EXPERT_TOPK = 2
D_EXPERT = 256
LN_EPS = 1e-5
IN_COLS = 3 * CONV_WIDTH + 3 * ATTN_WIDTH + 2 * D_MODEL
SPLITS = [CONV_WIDTH, 2 * CONV_WIDTH, 3 * CONV_WIDTH,
          3 * CONV_WIDTH + ATTN_WIDTH, 3 * CONV_WIDTH + 2 * ATTN_WIDTH,
          3 * CONV_WIDTH + 3 * ATTN_WIDTH, 3 * CONV_WIDTH + 3 * ATTN_WIDTH + D_MODEL]

kernel_name = 'hybrid_conv_moba_hmoe'


def layer_norm(x, g, b):
    xf = x.astype(jnp.float32)
    mu = jnp.mean(xf, axis=-1, keepdims=True)
    var = jnp.mean(jnp.square(xf - mu), axis=-1, keepdims=True)
    return ((xf - mu) * lax.rsqrt(var + LN_EPS) * g + b).astype(x.dtype)


def causal_depthwise_conv(u, w):
    return lax.conv_general_dilated(
        u, w[:, None, :].astype(u.dtype), window_strides=(1,),
        padding=[(CONV_KERNEL - 1, 0)], dimension_numbers=('NWC', 'WIO', 'NWC'),
        feature_group_count=u.shape[-1])


def alibi_slopes():
    return jnp.asarray(2.0 ** (-8.0 * np.arange(1, N_HEADS + 1) / N_HEADS), jnp.float32)


def moba_attention(q, k, v, slopes):
    nb_, h_, s_, hd = q.shape
    s_pad = -(-s_ // MOBA_BLOCK) * MOBA_BLOCK
    pad = ((0, 0), (0, 0), (0, s_pad - s_), (0, 0))
    nblk = s_pad // MOBA_BLOCK
    kb = jnp.pad(k, pad).reshape(nb_, h_, nblk, MOBA_BLOCK, hd)
    vb = jnp.pad(v, pad).reshape(nb_, h_, nblk, MOBA_BLOCK, hd)
    kmean = jnp.mean(kb, axis=3)
    topk = min(MOBA_TOPK, nblk)
    n_chunks = s_ // QUERY_CHUNK
    qc = q.reshape(nb_, h_, n_chunks, QUERY_CHUNK, hd).transpose(2, 0, 1, 3, 4)
    scale = HEAD_DIM ** -0.5
    bidx = jnp.arange(nb_)[:, None, None, None]
    hidx = jnp.arange(h_)[None, :, None, None]
    offs = jnp.arange(MOBA_BLOCK)
    blk_ids = jnp.arange(nblk)

    def chunk_step(args):
        ci, qi = args
        t = ci * QUERY_CHUNK + jnp.arange(QUERY_CHUNK)
        own = (ci * QUERY_CHUNK) // MOBA_BLOCK
        gate = jnp.einsum('bhqd,bhnd->bhqn', qi, kmean).astype(jnp.float32)
        gate = jnp.where(blk_ids < own, gate, -jnp.inf)
        _, sel = lax.top_k(gate, topk)
        sel_valid = sel < own
        k_sel = kb[bidx, hidx, sel]
        v_sel = vb[bidx, hidx, sel]
        pos_past = sel[..., None] * MOBA_BLOCK + offs
        s_past = jnp.einsum('bhqd,bhqnkd->bhqnk', qi, k_sel).astype(jnp.float32) * scale
        s_past = s_past - slopes[:, None, None, None] * (t[:, None, None] - pos_past)
        s_past = jnp.where(sel_valid[..., None], s_past, -jnp.inf)
        k_own = lax.dynamic_slice_in_dim(kb, own, 1, axis=2)[:, :, 0]
        v_own = lax.dynamic_slice_in_dim(vb, own, 1, axis=2)[:, :, 0]
        pos_own = own * MOBA_BLOCK + offs
        s_own = jnp.einsum('bhqd,bhkd->bhqk', qi, k_own).astype(jnp.float32) * scale
        s_own = s_own - slopes[:, None, None] * (t[:, None] - pos_own)
        s_own = jnp.where(pos_own <= t[:, None], s_own, -jnp.inf)
        scores = jnp.concatenate(
            [s_past.reshape(nb_, h_, QUERY_CHUNK, topk * MOBA_BLOCK), s_own], axis=-1)
        p = jax.nn.softmax(scores, axis=-1).astype(v.dtype)
        p_past = p[..., :topk * MOBA_BLOCK].reshape(nb_, h_, QUERY_CHUNK, topk, MOBA_BLOCK)
        p_own = p[..., topk * MOBA_BLOCK:]
        return (jnp.einsum('bhqnk,bhqnkd->bhqd', p_past, v_sel)
                + jnp.einsum('bhqk,bhkd->bhqd', p_own, v_own))

    out = lax.map(chunk_step, (jnp.arange(n_chunks), qc))
    return out.transpose(1, 2, 0, 3, 4).reshape(nb_, h_, s_, hd)


def hybrid_mixer(x, w_in, conv_w, w_out_conv, w_out_attn, w_o, slopes):
    nb_, s_, _ = x.shape
    proj = jnp.einsum('bsd,dc->bsc', x, w_in)
    c_b, c_c, c_x, q, k, v, g_a, g_b = jnp.split(proj, SPLITS, axis=-1)
    y_conv = jnp.einsum('bsc,cd->bsd', c_b * causal_depthwise_conv(c_c * c_x, conv_w), w_out_conv)
    heads = lambda z: z.reshape(nb_, s_, N_HEADS, HEAD_DIM).transpose(0, 2, 1, 3)
    o = moba_attention(heads(q), heads(k), heads(v), slopes)
    o = o.transpose(0, 2, 1, 3).reshape(nb_, s_, ATTN_WIDTH)
    y_attn = jnp.einsum('bsc,cd->bsd', o, w_out_attn)
    y = jax.nn.sigmoid(g_a) * y_conv + jax.nn.sigmoid(g_b) * y_attn
    return jnp.einsum('bsd,de->bse', y, w_o)


def hierarchical_moe(x, w_router_group, w_router_expert, w_gate, w_up, w_down):
    nb_, s_, d_ = x.shape
    xt = x.reshape(-1, d_)
    g_prob = jax.nn.softmax((xt @ w_router_group).astype(jnp.float32), axis=-1)
    g_top_p, g_top = lax.top_k(g_prob, 1)
    e_logits = (xt @ w_router_expert).astype(jnp.float32).reshape(-1, N_GROUPS, EXPERTS_PER_GROUP)
    e_in_group = jnp.take_along_axis(e_logits, g_top[:, :, None], axis=1)[:, 0]
    e_top_logit, e_top = lax.top_k(e_in_group, EXPERT_TOPK)
    gate = g_top_p * jax.nn.softmax(e_top_logit, axis=-1)
    expert_id = g_top * EXPERTS_PER_GROUP + e_top
    combine = jnp.sum(jax.nn.one_hot(expert_id, N_EXPERTS, dtype=jnp.float32)
                      * gate[..., None], axis=1)
    h = (jax.nn.silu(jnp.einsum('td,edf->tef', xt, w_gate))
         * jnp.einsum('td,edf->tef', xt, w_up)
         * combine[..., None].astype(x.dtype))
    return jnp.einsum('tef,efd->td', h, w_down).reshape(nb_, s_, d_)


def setup_inputs(seed: int = 0) -> dict:
    key = jax.random.key(seed)
    ks = jax.random.split(key, 16)
    beta = (8.0 * DEPTH) ** -0.25
    nrm = lambda k, shape, sc: jax.random.normal(k, shape, jnp.float32) * sc
    ones = lambda n: jnp.ones((n,), jnp.float32)
    col_scale = jnp.concatenate([
        ones(CONV_WIDTH), ones(CONV_WIDTH), beta * ones(CONV_WIDTH),
        ones(ATTN_WIDTH), ones(ATTN_WIDTH), beta * ones(ATTN_WIDTH), ones(2 * D_MODEL)])
    return {
        'x': nrm(ks[0], (BATCH, SEQ, D_MODEL), 1.0),
        'w_in': nrm(ks[1], (DEPTH, D_MODEL, IN_COLS), D_MODEL ** -0.5) * col_scale,
        'conv_w': nrm(ks[2], (DEPTH, CONV_KERNEL, CONV_WIDTH), CONV_KERNEL ** -0.5),
        'w_out_conv': nrm(ks[3], (DEPTH, CONV_WIDTH, D_MODEL), beta * CONV_WIDTH ** -0.5),
        'w_out_attn': nrm(ks[4], (DEPTH, ATTN_WIDTH, D_MODEL), beta * ATTN_WIDTH ** -0.5),
        'w_o': nrm(ks[5], (DEPTH, D_MODEL, D_MODEL), beta * D_MODEL ** -0.5),
        'ln1_g': 1.0 + nrm(ks[6], (DEPTH, D_MODEL), 0.02),
        'ln1_b': nrm(ks[7], (DEPTH, D_MODEL), 0.02),
        'w_router_group': nrm(ks[8], (DEPTH, D_MODEL, N_GROUPS), D_MODEL ** -0.5),
        'w_router_expert': nrm(ks[9], (DEPTH, D_MODEL, N_EXPERTS), D_MODEL ** -0.5),
        'w_gate': nrm(ks[10], (DEPTH, N_EXPERTS, D_MODEL, D_EXPERT), beta * D_MODEL ** -0.5),
        'w_up': nrm(ks[11], (DEPTH, N_EXPERTS, D_MODEL, D_EXPERT), beta * D_MODEL ** -0.5),
        'w_down': nrm(ks[12], (DEPTH, N_EXPERTS, D_EXPERT, D_MODEL), beta * D_EXPERT ** -0.5),
        'ln2_g': 1.0 + nrm(ks[13], (DEPTH, D_MODEL), 0.02),
        'ln2_b': nrm(ks[14], (DEPTH, D_MODEL), 0.02),
    }


def reference(x, w_in, conv_w, w_out_conv, w_out_attn, w_o, ln1_g, ln1_b,
              w_router_group, w_router_expert, w_gate, w_up, w_down, ln2_g, ln2_b):
    alpha = (2.0 * DEPTH) ** 0.25
    slopes = alibi_slopes()
    for l in range(DEPTH):
        mix = hybrid_mixer(x, w_in[l], conv_w[l], w_out_conv[l], w_out_attn[l], w_o[l], slopes)
        x = layer_norm(alpha * x + mix, ln1_g[l], ln1_b[l])
        ffn = hierarchical_moe(x, w_router_group[l], w_router_expert[l], w_gate[l], w_up[l], w_down[l])
        x = layer_norm(alpha * x + ffn, ln2_g[l], ln2_b[l])
    return x
```

```cpp
#include <hip/hip_runtime.h>
#include <cstdint>
#include <cstdio>

typedef unsigned short bf16_t;
typedef unsigned u32x4 __attribute__((ext_vector_type(4)));
typedef float f32x4 __attribute__((ext_vector_type(4)));

constexpr int D = 1024, BATCH = 8, SEQ = 2048, M = BATCH * SEQ;
constexpr int NH = 8, HD = 64, MBLK = 256, NBLK = SEQ / MBLK;
constexpr int NE = 32, DE = 256, INC = 5120;
constexpr float LN_EPS = 1e-5f;
constexpr float ALPHA = 1.189207115002721f;
constexpr float LOG2E = 1.4426950408889634f;
constexpr float C2 = 0.125f * LOG2E;
constexpr int PC_CC = 0, PC_CX = 512, PC_CB = 1024, PC_Q = 1536, PC_K = 2048, PC_V = 2560, PC_GA = 3072, PC_GB = 4096;

constexpr size_t MiB = 1u << 20;
constexpr size_t WS_CTL = 0, CTL_BYTES = 1 * MiB;
constexpr size_t WS_XSUM = 1 * MiB;
constexpr size_t WS_KMEAN = 2 * MiB;
constexpr size_t WS_ROUTE = 2 * MiB + 512 * 1024;
constexpr size_t WS_LIST = 3 * MiB;
constexpr size_t WS_WGU = 8 * MiB;
constexpr size_t WS_WD = 40 * MiB;
constexpr size_t WS_WO = 56 * MiB;
constexpr size_t WS_WCAT = 58 * MiB;
constexpr size_t WS_WIN = 60 * MiB;
constexpr size_t WS_X1B = 60 * MiB;
constexpr size_t WS_PROJ = 96 * MiB;
constexpr size_t WS_H = 96 * MiB;
constexpr size_t WS_C = 112 * MiB;
constexpr size_t WS_GU = 176 * MiB;
constexpr size_t WS_END = 256 * MiB;
constexpr int CW_CNT = 1024;

struct Prm {
    const float *x, *w_in, *conv_w, *w_oc, *w_oa, *w_o, *ln1g, *ln1b, *w_rg, *w_re, *w_gate, *w_up, *w_down, *ln2g, *ln2b;
    float* out; unsigned char* ws;
};

__device__ __forceinline__ float bf2f(unsigned v) { return __uint_as_float(v << 16); }
__device__ __forceinline__ unsigned f2bf(float f) { unsigned u = __float_as_uint(f); return (u + 0x7fffu + ((u >> 16) & 1u)) >> 16; }
__device__ __forceinline__ unsigned pk2(float lo, float hi) { return f2bf(lo) | (f2bf(hi) << 16); }
__device__ __forceinline__ float wave_sum(float v) {
#pragma unroll
    for (int o = 1; o < 64; o <<= 1) v += __shfl_xor(v, o);
    return v;
}
__device__ __forceinline__ float sigmoidf_(float x) { return 1.f / (1.f + __expf(-x)); }

__device__ __forceinline__ void tr_item(const float* src, int ld, int k0, int c0, bf16_t* dst, int Kd, int n0, int k0d, float scale, float* scr, int lane) {
#pragma unroll 8
    for (int i = 0; i < 32; ++i) { const int kk = 2 * i + (lane >> 5); scr[kk * 33 + (lane & 31)] = src[(size_t)(k0 + kk) * ld + c0 + (lane & 31)] * scale; }
    asm volatile("s_waitcnt lgkmcnt(0)" ::: "memory");
    const int c = lane & 7;
#pragma unroll
    for (int j = 0; j < 4; ++j) { const int n = (lane >> 3) + 8 * j; const float* s = scr + (8 * c) * 33 + n;
        u32x4 o; o.x = pk2(s[0 * 33], s[1 * 33]); o.y = pk2(s[2 * 33], s[3 * 33]); o.z = pk2(s[4 * 33], s[5 * 33]); o.w = pk2(s[6 * 33], s[7 * 33]);
        *(u32x4*)(dst + (size_t)(n0 + n) * Kd + k0d + 8 * c) = o; }
    asm volatile("s_waitcnt lgkmcnt(0)" ::: "memory");
}

constexpr int IT_WIN = 16 * 160, IT_WCAT = 16 * 32, IT_WO = 16 * 32, IT_WGU = 32 * 16 * 16, IT_WD = 32 * 4 * 32;
constexpr int IT_TOTAL = IT_WIN + IT_WCAT + IT_WO + IT_WGU + IT_WD;

__device__ void p0_prologue(const Prm& p, unsigned char* lds, int wg, int nwg) {
    const int tid = threadIdx.x, lane = tid & 63, wave = tid >> 6;
    float* scr = (float*)(lds + wave * 16384);
    const int gw = wg * 8 + wave, NGW = nwg * 8;
    bf16_t* WIN = (bf16_t*)(p.ws + WS_WIN); bf16_t* WCAT = (bf16_t*)(p.ws + WS_WCAT); bf16_t* WO = (bf16_t*)(p.ws + WS_WO);
    bf16_t* WGU = (bf16_t*)(p.ws + WS_WGU); bf16_t* WD = (bf16_t*)(p.ws + WS_WD);
    for (int it = gw; it < IT_TOTAL; it += NGW) {
        int r = it;
        if (r < IT_WIN) {
            const int kb = r / 160, nb = r % 160, n0 = nb * 32;
            int c0; if (n0 < 1024) c0 = n0 + 512; else if (n0 < 1536) c0 = n0 - 1024; else c0 = n0;
            const float sc = (n0 >= PC_Q && n0 < PC_K) ? C2 : 1.f;
            tr_item(p.w_in, INC, kb * 64, c0, WIN, D, n0, kb * 64, sc, scr, lane); continue; }
        r -= IT_WIN;
        if (r < IT_WCAT) { const int kb = r / 32, nb = r % 32;
            if (kb < 8) tr_item(p.w_oc, D, kb * 64, nb * 32, WCAT, D, nb * 32, kb * 64, 1.f, scr, lane);
            else tr_item(p.w_oa, D, (kb - 8) * 64, nb * 32, WCAT, D, nb * 32, kb * 64, 1.f, scr, lane);
            continue; }
        r -= IT_WCAT;
        if (r < IT_WO) { const int kb = r / 32, nb = r % 32; tr_item(p.w_o, D, kb * 64, nb * 32, WO, D, nb * 32, kb * 64, 1.f, scr, lane); continue; }
        r -= IT_WO;
        if (r < IT_WGU) { const int e = r / 256, q = r % 256, kb = q / 16, nb = q % 16, n0 = nb * 32;
            const int pn = n0 >> 8, bj = (n0 >> 7) & 1, f0 = 128 * pn + (n0 & 127);
            const float* src = (bj ? p.w_up : p.w_gate) + (size_t)e * D * DE;
            tr_item(src, DE, kb * 64, f0, WGU + (size_t)e * 512 * D, D, n0, kb * 64, 1.f, scr, lane); continue; }
        r -= IT_WGU;
        { const int e = r / 128, q = r % 128, kb = q / 32, nb = q % 32;
          tr_item(p.w_down + (size_t)e * DE * D, D, kb * 64, nb * 32, WD + (size_t)e * D * DE, DE, nb * 32, kb * 64, 1.f, scr, lane); }
    }
    bf16_t* XB = (bf16_t*)p.out; float* XSUM = (float*)(p.ws + WS_XSUM);
    float* part = (float*)(lds + wave * 16384 + 12288);
    for (int rg = wg; rg < 256; rg += nwg) {
        float cs[16];
#pragma unroll
        for (int i = 0; i < 16; ++i) cs[i] = 0.f;
        for (int i = 0; i < 8; ++i) {
            const int row = rg * 64 + wave * 8 + i;
            const f32x4* xr = (const f32x4*)(p.x + (size_t)row * D) + lane;
            unsigned long long* o8 = (unsigned long long*)(XB + (size_t)row * D) + lane;
#pragma unroll
            for (int j = 0; j < 4; ++j) { const f32x4 v = xr[64 * j]; cs[4 * j] += v.x; cs[4 * j + 1] += v.y; cs[4 * j + 2] += v.z; cs[4 * j + 3] += v.w;
                o8[64 * j] = (unsigned long long)pk2(v.x, v.y) | ((unsigned long long)pk2(v.z, v.w) << 32); }
        }
#pragma unroll
        for (int j = 0; j < 4; ++j) *(f32x4*)(part + j * 256 + lane * 4) = (f32x4){cs[4 * j], cs[4 * j + 1], cs[4 * j + 2], cs[4 * j + 3]};
        __syncthreads();
        { const int c = tid * 2; float s0 = 0.f, s1 = 0.f;
#pragma unroll
          for (int w = 0; w < 8; ++w) { const float* pw = (const float*)(lds + w * 16384 + 12288); s0 += pw[c]; s1 += pw[c + 1]; }
          XSUM[(size_t)rg * D + c] = s0; XSUM[(size_t)rg * D + c + 1] = s1; }
        __syncthreads();
    }
}

__device__ void kmean_items(const Prm& p, unsigned char* lds, int wg, int nwg) {
    const int tid = threadIdx.x; const float* XSUM = (const float*)(p.ws + WS_XSUM); float* KM = (float*)(p.ws + WS_KMEAN);
    float* red = (float*)lds;
    for (int it = wg; it < 256; it += nwg) {
        const int r = it >> 2, c = it & 3, j = tid & 127, kq = tid >> 7;
        float acc = 0.f;
        for (int k = kq * 256; k < kq * 256 + 256; ++k) {
            const float xm = (XSUM[(size_t)(4 * r) * D + k] + XSUM[(size_t)(4 * r + 1) * D + k]) + (XSUM[(size_t)(4 * r + 2) * D + k] + XSUM[(size_t)(4 * r + 3) * D + k]);
            acc += xm * p.w_in[(size_t)k * INC + 2048 + c * 128 + j];
        }
        red[kq * 128 + j] = acc; __syncthreads();
        if (tid < 128) KM[(size_t)r * 512 + c * 128 + tid] = ((red[tid] + red[128 + tid]) + (red[256 + tid] + red[384 + tid])) * (1.f / 256.f);
        __syncthreads();
    }
}

template <class Epi>
__device__ __forceinline__ void ngemm_tile(const bf16_t* A, int lda, const int* rowidx, int rshift, int Mrows, int m0, const bf16_t* Bt, int ldb, int n0, int K, unsigned char* lds, Epi epi) {
    const int tid = threadIdx.x, ty = tid >> 4, tx = tid & 15;
    float* As = (float*)lds; float* Bs = (float*)(lds + 32 * 132 * 4);
    float acc[4][4];
#pragma unroll
    for (int i = 0; i < 4; ++i)
#pragma unroll
        for (int j = 0; j < 4; ++j) acc[i][j] = 0.f;
    const int ar = tid >> 2, ac = (tid & 3) * 8; const int gr = m0 + ar;
    const bf16_t* arow = nullptr;
    if (gr < Mrows) { const int row = rowidx ? (rowidx[gr] >> rshift) : gr; arow = A + (size_t)row * lda; }
    for (int k0 = 0; k0 < K; k0 += 32) {
        u32x4 v = (u32x4){0u, 0u, 0u, 0u};
        if (arow) v = *(const u32x4*)(arow + k0 + ac);
        As[(ac + 0) * 132 + ar] = bf2f(v.x & 0xffffu); As[(ac + 1) * 132 + ar] = bf2f(v.x >> 16);
        As[(ac + 2) * 132 + ar] = bf2f(v.y & 0xffffu); As[(ac + 3) * 132 + ar] = bf2f(v.y >> 16);
        As[(ac + 4) * 132 + ar] = bf2f(v.z & 0xffffu); As[(ac + 5) * 132 + ar] = bf2f(v.z >> 16);
        As[(ac + 6) * 132 + ar] = bf2f(v.w & 0xffffu); As[(ac + 7) * 132 + ar] = bf2f(v.w >> 16);
        if (tid < 256) { const u32x4 w = *(const u32x4*)(Bt + (size_t)(n0 + ar) * ldb + k0 + ac);
            Bs[(ac + 0) * 68 + ar] = bf2f(w.x & 0xffffu); Bs[(ac + 1) * 68 + ar] = bf2f(w.x >> 16);
            Bs[(ac + 2) * 68 + ar] = bf2f(w.y & 0xffffu); Bs[(ac + 3) * 68 + ar] = bf2f(w.y >> 16);
            Bs[(ac + 4) * 68 + ar] = bf2f(w.z & 0xffffu); Bs[(ac + 5) * 68 + ar] = bf2f(w.z >> 16);
            Bs[(ac + 6) * 68 + ar] = bf2f(w.w & 0xffffu); Bs[(ac + 7) * 68 + ar] = bf2f(w.w >> 16); }
        __syncthreads();
#pragma unroll 8
        for (int kk = 0; kk < 32; ++kk) {
            const f32x4 a = *(const f32x4*)(As + kk * 132 + ty * 4); const f32x4 b = *(const f32x4*)(Bs + kk * 68 + tx * 4);
#pragma unroll
            for (int i = 0; i < 4; ++i)
#pragma unroll
                for (int j = 0; j < 4; ++j) acc[i][j] = fmaf(a[i], b[j], acc[i][j]);
        }
        __syncthreads();
    }
#pragma unroll
    for (int i = 0; i < 4; ++i) { const int m = m0 + ty * 4 + i; if (m < Mrows) {
#pragma unroll
        for (int j = 0; j < 4; ++j) epi(m, n0 + tx * 4 + j, acc[i][j]); } }
}

__device__ void p1_inproj(const Prm& p, unsigned char* lds, int wg, int nwg) {
    kmean_items(p, lds, wg, nwg);
    const bf16_t* XB = (const bf16_t*)p.out; const bf16_t* WIN = (const bf16_t*)(p.ws + WS_WIN); bf16_t* PROJ = (bf16_t*)(p.ws + WS_PROJ);
    constexpr int TN = INC / 64, NT = (M / 128) * TN;
    for (int it = wg; it < NT; it += nwg) { const int tm = it / TN, tn = it % TN;
        ngemm_tile(XB, D, nullptr, 0, M, tm * 128, WIN, D, tn * 64, D, lds, [&](int m, int n, float v) { PROJ[(size_t)m * INC + n] = (bf16_t)f2bf(v); }); }
}

__device__ void p2_zpass(const Prm& p, int wg, int nwg) {
    bf16_t* PROJ = (bf16_t*)(p.ws + WS_PROJ);
    for (int it = wg * 512 + threadIdx.x; it < M * 64; it += nwg * 512) {
        const int row = it >> 6, c0 = (it & 63) * 8, t = row & (SEQ - 1);
        float u[3][8];
#pragma unroll
        for (int s = 0; s < 3; ++s) { const int tt = t - 2 + s;
            if (tt >= 0) { const bf16_t* r = PROJ + (size_t)(row - 2 + s) * INC; const u32x4 a = *(const u32x4*)(r + PC_CC + c0), b = *(const u32x4*)(r + PC_CX + c0);
#pragma unroll
                for (int i = 0; i < 4; ++i) { u[s][2 * i] = bf2f(a[i] & 0xffffu) * bf2f(b[i] & 0xffffu); u[s][2 * i + 1] = bf2f(a[i] >> 16) * bf2f(b[i] >> 16); } }
            else {
#pragma unroll
                for (int i = 0; i < 8; ++i) u[s][i] = 0.f; } }
        const u32x4 cb = *(const u32x4*)(PROJ + (size_t)row * INC + PC_CB + c0);
        float z[8];
#pragma unroll
        for (int i = 0; i < 8; ++i) { const float w0 = p.conv_w[c0 + i], w1 = p.conv_w[512 + c0 + i], w2 = p.conv_w[1024 + c0 + i];
            const float cbv = bf2f((i & 1) ? (cb[i >> 1] >> 16) : (cb[i >> 1] & 0xffffu));
            z[i] = cbv * (w0 * u[0][i] + w1 * u[1][i] + w2 * u[2][i]); }
        u32x4 o; o.x = pk2(z[0], z[1]); o.y = pk2(z[2], z[3]); o.z = pk2(z[4], z[5]); o.w = pk2(z[6], z[7]);
        *(u32x4*)(PROJ + (size_t)row * INC + PC_CB + c0) = o;
    }
}

__device__ void p2_attn_naive(const Prm& p, int wg, int nwg) {
    bf16_t* PROJ = (bf16_t*)(p.ws + WS_PROJ); const float* KM = (const float*)(p.ws + WS_KMEAN);
    for (int item = wg * 512 + threadIdx.x; item < BATCH * NH * SEQ; item += nwg * 512) {
        const int t = item & (SEQ - 1), h = (item >> 11) & 7, b = item >> 14, qb = t >> 8;
        const size_t row = (size_t)b * SEQ + t;
        float q[64];
        { const u32x4* qp = (const u32x4*)(PROJ + row * INC + PC_Q + h * 64);
#pragma unroll
          for (int i = 0; i < 8; ++i) { const u32x4 v = qp[i];
#pragma unroll
              for (int j = 0; j < 4; ++j) { q[8 * i + 2 * j] = bf2f(v[j] & 0xffffu); q[8 * i + 2 * j + 1] = bf2f(v[j] >> 16); } } }
        float g[7];
#pragma unroll
        for (int n = 0; n < 7; ++n) { g[n] = -INFINITY;
            if (n < qb) { const float* km = KM + (size_t)(b * NBLK + n) * 512 + h * 64; float s = 0.f;
#pragma unroll
                for (int d = 0; d < 64; ++d) s = fmaf(q[d], km[d], s);
                g[n] = s; } }
        unsigned sel = 0;
#pragma unroll
        for (int n = 0; n < 7; ++n) { int rank = 0;
#pragma unroll
            for (int m2 = 0; m2 < 7; ++m2) if (m2 != n && m2 < qb) rank += (g[m2] > g[n] || (g[m2] == g[n] && m2 < n)) ? 1 : 0;
            if (n < qb && rank < 3) sel |= 1u << n; }
        const float a = exp2f(-(float)(h + 1)) * LOG2E;
        float mrun = -INFINITY, l = 0.f; float o[64];
#pragma unroll
        for (int d = 0; d < 64; ++d) o[d] = 0.f;
        for (int n = 0; n <= qb; ++n) {
            const bool blk_on = (n == qb) || ((sel >> n) & 1u);
            if (!__any(blk_on)) continue;
            for (int kk = 0; kk < MBLK; ++kk) {
                const int pos = n * MBLK + kk;
                const bool on = blk_on && (pos <= t);
                if (!__any(on)) continue;
                const bf16_t* kr = PROJ + ((size_t)b * SEQ + pos) * INC + PC_K + h * 64;
                float s = 0.f;
#pragma unroll
                for (int i = 0; i < 8; ++i) { const u32x4 v = ((const u32x4*)kr)[i];
#pragma unroll
                    for (int j = 0; j < 4; ++j) { s = fmaf(q[8 * i + 2 * j], bf2f(v[j] & 0xffffu), s); s = fmaf(q[8 * i + 2 * j + 1], bf2f(v[j] >> 16), s); } }
                s -= a * (float)(t - pos);
                if (on) {
                    const float mnew = fmaxf(mrun, s), corr = exp2f(mrun - mnew), pw = exp2f(s - mnew);
                    l = l * corr + pw; mrun = mnew;
                    const bf16_t* vr = kr + (PC_V - PC_K);
#pragma unroll
                    for (int i = 0; i < 8; ++i) { const u32x4 v = ((const u32x4*)vr)[i];
#pragma unroll
                        for (int j = 0; j < 4; ++j) { o[8 * i + 2 * j] = o[8 * i + 2 * j] * corr + pw * bf2f(v[j] & 0xffffu); o[8 * i + 2 * j + 1] = o[8 * i + 2 * j + 1] * corr + pw * bf2f(v[j] >> 16); } }
                }
            }
        }
        const float rl = 1.f / l;
        u32x4* op = (u32x4*)(PROJ + row * INC + PC_Q + h * 64);
#pragma unroll
        for (int i = 0; i < 8; ++i) { u32x4 w; w.x = pk2(o[8 * i] * rl, o[8 * i + 1] * rl); w.y = pk2(o[8 * i + 2] * rl, o[8 * i + 3] * rl); w.z = pk2(o[8 * i + 4] * rl, o[8 * i + 5] * rl); w.w = pk2(o[8 * i + 6] * rl, o[8 * i + 7] * rl); op[i] = w; }
    }
}

__device__ void p3a_naive(const Prm& p, unsigned char* lds, int wg, int nwg) {
    bf16_t* PROJ = (bf16_t*)(p.ws + WS_PROJ); const bf16_t* WCAT = (const bf16_t*)(p.ws + WS_WCAT);
    constexpr int TN = D / 64, NT = (M / 128) * TN;
    for (int it = wg; it < NT; it += nwg) { const int tm = it / TN, tn = it % TN;
        ngemm_tile(PROJ + PC_CB, INC, nullptr, 0, M, tm * 128, WCAT, D, tn * 64, 512, lds, [&](int m, int n, float v) {
            bf16_t* yp = PROJ + (size_t)m * INC + PC_GA + n; *yp = (bf16_t)f2bf(sigmoidf_(bf2f(*yp)) * v); });
        ngemm_tile(PROJ + PC_Q, INC, nullptr, 0, M, tm * 128, WCAT + 512, D, tn * 64, 512, lds, [&](int m, int n, float v) {
            bf16_t* yp = PROJ + (size_t)m * INC + PC_GA + n; const float gb = bf2f(PROJ[(size_t)m * INC + PC_GB + n]); *yp = (bf16_t)f2bf(bf2f(*yp) + sigmoidf_(gb) * v); });
    }
}
__device__ void p3b_naive(const Prm& p, unsigned char* lds, int wg, int nwg) {
    const bf16_t* PROJ = (const bf16_t*)(p.ws + WS_PROJ); const bf16_t* WO = (const bf16_t*)(p.ws + WS_WO);
    constexpr int TN = D / 64, NT = (M / 128) * TN;
    for (int it = wg; it < NT; it += nwg) { const int tm = it / TN, tn = it % TN;
        ngemm_tile(PROJ + PC_GA, INC, nullptr, 0, M, tm * 128, WO, D, tn * 64, D, lds, [&](int m, int n, float v) { p.out[(size_t)m * D + n] = ALPHA * p.x[(size_t)m * D + n] + v; }); }
}
__device__ void p3c_ln_route(const Prm& p, int wg, int nwg) {
    const int tid = threadIdx.x, lane = tid & 63, wave = tid >> 6; const int gw = wg * 8 + wave, NGW = nwg * 8;
    bf16_t* X1B = (bf16_t*)(p.ws + WS_X1B); int* RE = (int*)(p.ws + WS_ROUTE); float* RG = (float*)(p.ws + WS_ROUTE + (size_t)M * 8);
    int* LIST = (int*)(p.ws + WS_LIST); unsigned* CNT = (unsigned*)(p.ws + WS_CTL) + CW_CNT;
    for (int m = gw; m < M; m += NGW) {
        f32x4* xr = (f32x4*)(p.out + (size_t)m * D) + lane;
        f32x4 v[4]; float s = 0.f;
#pragma unroll
        for (int j = 0; j < 4; ++j) { v[j] = xr[64 * j]; s += (v[j].x + v[j].y) + (v[j].z + v[j].w); }
        const float mean = wave_sum(s) * (1.f / D); float s2 = 0.f;
#pragma unroll
        for (int j = 0; j < 4; ++j) { v[j] = v[j] - mean; s2 += (v[j].x * v[j].x + v[j].y * v[j].y) + (v[j].z * v[j].z + v[j].w * v[j].w); }
        const float rstd = 1.f / sqrtf(wave_sum(s2) * (1.f / D) + LN_EPS);
        unsigned long long* o8 = (unsigned long long*)(X1B + (size_t)m * D) + lane;
#pragma unroll
        for (int j = 0; j < 4; ++j) { const f32x4 g = ((const f32x4*)p.ln1g)[64 * j + lane], bb = ((const f32x4*)p.ln1b)[64 * j + lane];
            v[j] = v[j] * rstd * g + bb; xr[64 * j] = v[j];
            o8[64 * j] = (unsigned long long)pk2(v[j].x, v[j].y) | ((unsigned long long)pk2(v[j].z, v[j].w) << 32); }
        float lg[4], le[32];
#pragma unroll
        for (int c = 0; c < 4; ++c) { float a = 0.f;
#pragma unroll
            for (int j = 0; j < 4; ++j) { const int k = 256 * j + 4 * lane; a += v[j].x * p.w_rg[(size_t)k * 4 + c] + v[j].y * p.w_rg[(size_t)(k + 1) * 4 + c] + v[j].z * p.w_rg[(size_t)(k + 2) * 4 + c] + v[j].w * p.w_rg[(size_t)(k + 3) * 4 + c]; }
            lg[c] = wave_sum(a); }
#pragma unroll
        for (int c = 0; c < 32; ++c) { float a = 0.f;
#pragma unroll
            for (int j = 0; j < 4; ++j) { const int k = 256 * j + 4 * lane; a += v[j].x * p.w_re[(size_t)k * 32 + c] + v[j].y * p.w_re[(size_t)(k + 1) * 32 + c] + v[j].z * p.w_re[(size_t)(k + 2) * 32 + c] + v[j].w * p.w_re[(size_t)(k + 3) * 32 + c]; }
            le[c] = wave_sum(a); }
        int gt = 0; float gm = lg[0];
#pragma unroll
        for (int c = 1; c < 4; ++c) if (lg[c] > gm) { gm = lg[c]; gt = c; }
        float gs = 0.f;
#pragma unroll
        for (int c = 0; c < 4; ++c) gs += __expf(lg[c] - gm);
        const float gp = 1.f / gs;
        float l8[8];
#pragma unroll
        for (int c = 0; c < 8; ++c) { l8[c] = le[c];
#pragma unroll
            for (int g2 = 1; g2 < 4; ++g2) if (gt == g2) l8[c] = le[8 * g2 + c]; }
        int e0 = 0; float v0 = l8[0];
#pragma unroll
        for (int c = 1; c < 8; ++c) if (l8[c] > v0) { v0 = l8[c]; e0 = c; }
        int e1 = -1; float v1 = -INFINITY;
#pragma unroll
        for (int c = 0; c < 8; ++c) if (c != e0 && l8[c] > v1) { v1 = l8[c]; e1 = c; }
        const float ex = __expf(v1 - v0), w0 = gp / (1.f + ex), w1 = gp * ex / (1.f + ex);
        if (lane == 0) {
            const int E0 = gt * 8 + e0, E1 = gt * 8 + e1;
            RE[2 * m] = E0; RE[2 * m + 1] = E1; RG[2 * m] = w0; RG[2 * m + 1] = w1;
            const unsigned p0 = atomicAdd(CNT + E0, 1u); LIST[(size_t)E0 * M + p0] = 2 * m;
            const unsigned p1 = atomicAdd(CNT + E1, 1u); LIST[(size_t)E1 * M + p1] = 2 * m + 1;
        }
    }
}
__device__ __forceinline__ bool moe_item(const unsigned* CNT, int it, int tn_count, int& e, int& tm, int& tn, int& off, int& cnt) {
    int base = 0, o = 0;
    for (int ee = 0; ee < NE; ++ee) { const int c = (int)CNT[ee]; const int tiles = ((c + 127) >> 7) * tn_count;
        if (it < base + tiles) { const int r = it - base; e = ee; tm = r / tn_count; tn = r % tn_count; off = o; cnt = c; return true; }
        base += tiles; o += c; }
    return false;
}
__device__ void p4a_gu(const Prm& p, unsigned char* lds, int wg, int nwg) {
    const unsigned* CNT = (const unsigned*)(p.ws + WS_CTL) + CW_CNT; const int* LIST = (const int*)(p.ws + WS_LIST);
    const bf16_t* X1B = (const bf16_t*)(p.ws + WS_X1B); const bf16_t* WGU = (const bf16_t*)(p.ws + WS_WGU); float* GU = (float*)(p.ws + WS_GU);
    for (int it = wg;; it += nwg) { int e, tm, tn, off, cnt; if (!moe_item(CNT, it, 8, e, tm, tn, off, cnt)) break;
        float* gu = GU + (size_t)off * 512;
        ngemm_tile(X1B, D, LIST + (size_t)e * M, 1, cnt, tm * 128, WGU + (size_t)e * 512 * D, D, tn * 64, D, lds, [&](int m, int n, float v) { gu[(size_t)m * 512 + n] = v; }); }
}
__device__ void p4b_h(const Prm& p, int wg, int nwg) {
    const unsigned* CNT = (const unsigned*)(p.ws + WS_CTL) + CW_CNT; const int* LIST = (const int*)(p.ws + WS_LIST);
    const float* GU = (const float*)(p.ws + WS_GU); bf16_t* H = (bf16_t*)(p.ws + WS_H); const float* RG = (const float*)(p.ws + WS_ROUTE + (size_t)M * 8);
    int off = 0;
    for (int e = 0; e < NE; ++e) { const int cnt = (int)CNT[e];
        for (int i = wg * 512 + threadIdx.x; i < cnt * 256; i += nwg * 512) { const int m = i >> 8, f = i & 255, pn = f >> 7, j = f & 127;
            const float g = GU[(size_t)(off + m) * 512 + pn * 256 + j], u = GU[(size_t)(off + m) * 512 + pn * 256 + 128 + j];
            const float w = RG[LIST[(size_t)e * M + m]];
            H[(size_t)(off + m) * 256 + f] = (bf16_t)f2bf(g * sigmoidf_(g) * u * w); }
        off += cnt; }
}
__device__ void p4c_down(const Prm& p, unsigned char* lds, int wg, int nwg) {
    const unsigned* CNT = (const unsigned*)(p.ws + WS_CTL) + CW_CNT; const int* LIST = (const int*)(p.ws + WS_LIST);
    const bf16_t* H = (const bf16_t*)(p.ws + WS_H); const bf16_t* WD = (const bf16_t*)(p.ws + WS_WD); bf16_t* C = (bf16_t*)(p.ws + WS_C);
    for (int it = wg;; it += nwg) { int e, tm, tn, off, cnt; if (!moe_item(CNT, it, 16, e, tm, tn, off, cnt)) break;
        const int* lst = LIST + (size_t)e * M;
        ngemm_tile(H + (size_t)off * 256, 256, nullptr, 0, cnt, tm * 128, WD + (size_t)e * D * DE, DE, tn * 64, DE, lds, [&](int m, int n, float v) { C[(size_t)lst[m] * D + n] = (bf16_t)f2bf(v); }); }
}
__device__ void p5_final(const Prm& p, int wg, int nwg) {
    const int tid = threadIdx.x, lane = tid & 63, wave = tid >> 6; const int gw = wg * 8 + wave, NGW = nwg * 8;
    const bf16_t* C = (const bf16_t*)(p.ws + WS_C);
    for (int m = gw; m < M; m += NGW) {
        f32x4* xr = (f32x4*)(p.out + (size_t)m * D) + lane;
        const unsigned long long* c0 = (const unsigned long long*)(C + (size_t)(2 * m) * D) + lane; const unsigned long long* c1 = (const unsigned long long*)(C + (size_t)(2 * m + 1) * D) + lane;
        f32x4 v[4]; float s = 0.f;
#pragma unroll
        for (int j = 0; j < 4; ++j) { v[j] = xr[64 * j]; const unsigned long long a = c0[64 * j], b = c1[64 * j];
            v[j].x = ALPHA * v[j].x + (bf2f((unsigned)a & 0xffffu) + bf2f((unsigned)b & 0xffffu)); v[j].y = ALPHA * v[j].y + (bf2f(((unsigned)a) >> 16) + bf2f(((unsigned)b) >> 16));
            v[j].z = ALPHA * v[j].z + (bf2f((unsigned)(a >> 32) & 0xffffu) + bf2f((unsigned)(b >> 32) & 0xffffu)); v[j].w = ALPHA * v[j].w + (bf2f((unsigned)(a >> 48)) + bf2f((unsigned)(b >> 48)));
            s += (v[j].x + v[j].y) + (v[j].z + v[j].w); }
        const float mean = wave_sum(s) * (1.f / D); float s2 = 0.f;
#pragma unroll
        for (int j = 0; j < 4; ++j) { v[j] = v[j] - mean; s2 += (v[j].x * v[j].x + v[j].y * v[j].y) + (v[j].z * v[j].z + v[j].w * v[j].w); }
        const float rstd = 1.f / sqrtf(wave_sum(s2) * (1.f / D) + LN_EPS);
#pragma unroll
        for (int j = 0; j < 4; ++j) { const f32x4 g = ((const f32x4*)p.ln2g)[64 * j + lane], bb = ((const f32x4*)p.ln2b)[64 * j + lane]; xr[64 * j] = v[j] * rstd * g + bb; }
    }
}

constexpr int LDS_BYTES = 147456;
template <int PH> __global__ void __launch_bounds__(512, 2) phase_kernel(Prm p) {
    extern __shared__ __attribute__((aligned(16))) unsigned char lds[];
    const int wg = blockIdx.x, nwg = gridDim.x;
    if (PH == 0) p0_prologue(p, lds, wg, nwg);
    if (PH == 1) p1_inproj(p, lds, wg, nwg);
    if (PH == 2) { p2_zpass(p, wg, nwg); p2_attn_naive(p, wg, nwg); }
    if (PH == 3) p3a_naive(p, lds, wg, nwg);
    if (PH == 4) p3b_naive(p, lds, wg, nwg);
    if (PH == 5) p3c_ln_route(p, wg, nwg);
    if (PH == 6) p4a_gu(p, lds, wg, nwg);
    if (PH == 7) p4b_h(p, wg, nwg);
    if (PH == 8) p4c_down(p, lds, wg, nwg);
    if (PH == 9) p5_final(p, wg, nwg);
}

template <int PH> static void launch_phase(const Prm& p, hipStream_t stream) {
    static bool attr = false;
    if (!attr) { (void)hipFuncSetAttribute((const void*)phase_kernel<PH>, hipFuncAttributeMaxDynamicSharedMemorySize, LDS_BYTES); attr = true; }
    hipLaunchKernelGGL(phase_kernel<PH>, dim3(256), dim3(512), LDS_BYTES, stream, p);
}

extern "C" void kernel_launch(void* const* d_in, const int* in_sizes, int n_in, void* d_out, int out_size, void* d_ws, size_t ws_size, hipStream_t stream) {
    if (n_in != 15 || out_size != M * D || ws_size < WS_END) { fprintf(stderr, "kernel_launch: unexpected shapes n_in %d out %d ws %zu\n", n_in, out_size, ws_size); return; }
    Prm p{};
    p.x = (const float*)d_in[0]; p.w_in = (const float*)d_in[1]; p.conv_w = (const float*)d_in[2]; p.w_oc = (const float*)d_in[3]; p.w_oa = (const float*)d_in[4];
    p.w_o = (const float*)d_in[5]; p.ln1g = (const float*)d_in[6]; p.ln1b = (const float*)d_in[7]; p.w_rg = (const float*)d_in[8]; p.w_re = (const float*)d_in[9];
    p.w_gate = (const float*)d_in[10]; p.w_up = (const float*)d_in[11]; p.w_down = (const float*)d_in[12]; p.ln2g = (const float*)d_in[13]; p.ln2b = (const float*)d_in[14];
    p.out = (float*)d_out; p.ws = (unsigned char*)d_ws;
    (void)hipMemsetAsync((char*)d_ws + WS_CTL, 0, CTL_BYTES, stream);
    launch_phase<0>(p, stream); launch_phase<1>(p, stream); launch_phase<2>(p, stream); launch_phase<3>(p, stream); launch_phase<4>(p, stream);
    launch_phase<5>(p, stream); launch_phase<6>(p, stream); launch_phase<7>(p, stream); launch_phase<8>(p, stream); launch_phase<9>(p, stream);
}
```

```cpp
#include <hip/hip_runtime.h>
#include <cstdint>
#include <cstdio>

typedef unsigned short bf16_t;
typedef unsigned u32x4 __attribute__((ext_vector_type(4)));
typedef float f32x4 __attribute__((ext_vector_type(4)));

constexpr int D = 1024, BATCH = 8, SEQ = 2048, M = BATCH * SEQ;
constexpr int NH = 8, HD = 64, MBLK = 256, NBLK = SEQ / MBLK;
constexpr int NE = 32, DE = 256, INC = 5120;
constexpr float LN_EPS = 1e-5f;
constexpr float ALPHA = 1.189207115002721f;
constexpr float LOG2E = 1.4426950408889634f;
constexpr float C2 = 0.125f * LOG2E;
constexpr int PC_CC = 0, PC_CX = 512, PC_CB = 1024, PC_Q = 1536, PC_K = 2048, PC_V = 2560, PC_GA = 3072, PC_GB = 4096;

constexpr size_t MiB = 1u << 20;
constexpr size_t WS_CTL = 0, CTL_BYTES = 1 * MiB;
constexpr size_t WS_XSUM = 1 * MiB;
constexpr size_t WS_KMEAN = 2 * MiB;
constexpr size_t WS_ROUTE = 2 * MiB + 512 * 1024;
constexpr size_t WS_LIST = 3 * MiB;
constexpr size_t WS_WGU = 8 * MiB;
constexpr size_t WS_WD = 40 * MiB;
constexpr size_t WS_WO = 56 * MiB;
constexpr size_t WS_WCAT = 58 * MiB;
constexpr size_t WS_WIN = 60 * MiB;
constexpr size_t WS_X1B = 60 * MiB;
constexpr size_t WS_PROJ = 96 * MiB;
constexpr size_t WS_H = 96 * MiB;
constexpr size_t WS_C = 112 * MiB;
constexpr size_t WS_GU = 176 * MiB;
constexpr size_t WS_END = 256 * MiB;
constexpr int CW_CNT = 1024;

struct Prm {
    const float *x, *w_in, *conv_w, *w_oc, *w_oa, *w_o, *ln1g, *ln1b, *w_rg, *w_re, *w_gate, *w_up, *w_down, *ln2g, *ln2b;
    float* out; unsigned char* ws;
};

__device__ __forceinline__ float bf2f(unsigned v) { return __uint_as_float(v << 16); }
__device__ __forceinline__ unsigned f2bf(float f) { unsigned u = __float_as_uint(f); return (u + 0x7fffu + ((u >> 16) & 1u)) >> 16; }
__device__ __forceinline__ unsigned pk2(float lo, float hi) { return f2bf(lo) | (f2bf(hi) << 16); }
__device__ __forceinline__ float wave_sum(float v) {
#pragma unroll
    for (int o = 1; o < 64; o <<= 1) v += __shfl_xor(v, o);
    return v;
}
__device__ __forceinline__ float sigmoidf_(float x) { return 1.f / (1.f + __expf(-x)); }

__device__ __forceinline__ void tr_item(const float* src, int ld, int k0, int c0, bf16_t* dst, int Kd, int n0, int k0d, float scale, float* scr, int lane) {
#pragma unroll 8
    for (int i = 0; i < 32; ++i) { const int kk = 2 * i + (lane >> 5); scr[kk * 33 + (lane & 31)] = src[(size_t)(k0 + kk) * ld + c0 + (lane & 31)] * scale; }
    asm volatile("s_waitcnt lgkmcnt(0)" ::: "memory");
    const int c = lane & 7;
#pragma unroll
    for (int j = 0; j < 4; ++j) { const int n = (lane >> 3) + 8 * j; const float* s = scr + (8 * c) * 33 + n;
        u32x4 o; o.x = pk2(s[0 * 33], s[1 * 33]); o.y = pk2(s[2 * 33], s[3 * 33]); o.z = pk2(s[4 * 33], s[5 * 33]); o.w = pk2(s[6 * 33], s[7 * 33]);
        *(u32x4*)(dst + (size_t)(n0 + n) * Kd + k0d + 8 * c) = o; }
    asm volatile("s_waitcnt lgkmcnt(0)" ::: "memory");
}

constexpr int IT_WIN = 16 * 160, IT_WCAT = 16 * 32, IT_WO = 16 * 32, IT_WGU = 32 * 16 * 16, IT_WD = 32 * 4 * 32;
constexpr int IT_TOTAL = IT_WIN + IT_WCAT + IT_WO + IT_WGU + IT_WD;

__device__ __forceinline__ void p0_prologue(const Prm& p, unsigned char* lds, int wg, int nwg) {
    const int tid = threadIdx.x, lane = tid & 63, wave = tid >> 6;
    float* scr = (float*)(lds + wave * 16384);
    const int gw = wg * 8 + wave, NGW = nwg * 8;
    bf16_t* WIN = (bf16_t*)(p.ws + WS_WIN); bf16_t* WCAT = (bf16_t*)(p.ws + WS_WCAT); bf16_t* WO = (bf16_t*)(p.ws + WS_WO);
    bf16_t* WGU = (bf16_t*)(p.ws + WS_WGU); bf16_t* WD = (bf16_t*)(p.ws + WS_WD);
    for (int it = gw; it < IT_TOTAL; it += NGW) {
        int r = it;
        if (r < IT_WIN) {
            const int kb = r / 160, nb = r % 160, n0 = nb * 32;
            int c0; if (n0 < 1024) c0 = n0 + 512; else if (n0 < 1536) c0 = n0 - 1024; else c0 = n0;
            const float sc = (n0 >= PC_Q && n0 < PC_K) ? C2 : 1.f;
            tr_item(p.w_in, INC, kb * 64, c0, WIN, D, n0, kb * 64, sc, scr, lane); continue; }
        r -= IT_WIN;
        if (r < IT_WCAT) { const int kb = r / 32, nb = r % 32;
            if (kb < 8) tr_item(p.w_oc, D, kb * 64, nb * 32, WCAT, D, nb * 32, kb * 64, 1.f, scr, lane);
            else tr_item(p.w_oa, D, (kb - 8) * 64, nb * 32, WCAT, D, nb * 32, kb * 64, 1.f, scr, lane);
            continue; }
        r -= IT_WCAT;
        if (r < IT_WO) { const int kb = r / 32, nb = r % 32; tr_item(p.w_o, D, kb * 64, nb * 32, WO, D, nb * 32, kb * 64, 1.f, scr, lane); continue; }
        r -= IT_WO;
        if (r < IT_WGU) { const int e = r / 256, q = r % 256, kb = q / 16, nb = q % 16, n0 = nb * 32;
            const int pn = n0 >> 8, bj = (n0 >> 7) & 1, f0 = 128 * pn + (n0 & 127);
            const float* src = (bj ? p.w_up : p.w_gate) + (size_t)e * D * DE;
            tr_item(src, DE, kb * 64, f0, WGU + (size_t)e * 512 * D, D, n0, kb * 64, 1.f, scr, lane); continue; }
        r -= IT_WGU;
        { const int e = r / 128, q = r % 128, kb = q / 32, nb = q % 32;
          tr_item(p.w_down + (size_t)e * DE * D, D, kb * 64, nb * 32, WD + (size_t)e * D * DE, DE, nb * 32, kb * 64, 1.f, scr, lane); }
    }
    bf16_t* XB = (bf16_t*)p.out; float* XSUM = (float*)(p.ws + WS_XSUM);
    float* part = (float*)(lds + wave * 16384 + 12288);
    for (int rg = wg; rg < 256; rg += nwg) {
        float cs[16];
#pragma unroll
        for (int i = 0; i < 16; ++i) cs[i] = 0.f;
        for (int i = 0; i < 8; ++i) {
            const int row = rg * 64 + wave * 8 + i;
            const f32x4* xr = (const f32x4*)(p.x + (size_t)row * D) + lane;
            unsigned long long* o8 = (unsigned long long*)(XB + (size_t)row * D) + lane;
#pragma unroll
            for (int j = 0; j < 4; ++j) { const f32x4 v = xr[64 * j]; cs[4 * j] += v.x; cs[4 * j + 1] += v.y; cs[4 * j + 2] += v.z; cs[4 * j + 3] += v.w;
                o8[64 * j] = (unsigned long long)pk2(v.x, v.y) | ((unsigned long long)pk2(v.z, v.w) << 32); }
        }
#pragma unroll
        for (int j = 0; j < 4; ++j) *(f32x4*)(part + j * 256 + lane * 4) = (f32x4){cs[4 * j], cs[4 * j + 1], cs[4 * j + 2], cs[4 * j + 3]};
        __syncthreads();
        { const int c = tid * 2; float s0 = 0.f, s1 = 0.f;
#pragma unroll
          for (int w = 0; w < 8; ++w) { const float* pw = (const float*)(lds + w * 16384 + 12288); s0 += pw[c]; s1 += pw[c + 1]; }
          XSUM[(size_t)rg * D + c] = s0; XSUM[(size_t)rg * D + c + 1] = s1; }
        __syncthreads();
    }
}

__device__ __forceinline__ void kmean_items(const Prm& p, unsigned char* lds, int wg, int nwg) {
    const int tid = threadIdx.x; const float* XSUM = (const float*)(p.ws + WS_XSUM); float* KM = (float*)(p.ws + WS_KMEAN);
    float* red = (float*)lds;
    for (int it = wg; it < 256; it += nwg) {
        const int r = it >> 2, c = it & 3, j = tid & 127, kq = tid >> 7;
        float acc = 0.f;
        for (int k = kq * 256; k < kq * 256 + 256; ++k) {
            const float xm = (XSUM[(size_t)(4 * r) * D + k] + XSUM[(size_t)(4 * r + 1) * D + k]) + (XSUM[(size_t)(4 * r + 2) * D + k] + XSUM[(size_t)(4 * r + 3) * D + k]);
            acc += xm * p.w_in[(size_t)k * INC + 2048 + c * 128 + j];
        }
        red[kq * 128 + j] = acc; __syncthreads();
        if (tid < 128) KM[(size_t)r * 512 + c * 128 + tid] = ((red[tid] + red[128 + tid]) + (red[256 + tid] + red[384 + tid])) * (1.f / 256.f);
        __syncthreads();
    }
}

template <class Epi>
__device__ __forceinline__ void ngemm_tile(const bf16_t* A, int lda, const int* rowidx, int rshift, int Mrows, int m0, const bf16_t* Bt, int ldb, int n0, int K, unsigned char* lds, Epi epi) {
    const int tid = threadIdx.x, ty = tid >> 4, tx = tid & 15;
    float* As = (float*)lds; float* Bs = (float*)(lds + 32 * 132 * 4);
    float acc[4][4];
#pragma unroll
    for (int i = 0; i < 4; ++i)
#pragma unroll
        for (int j = 0; j < 4; ++j) acc[i][j] = 0.f;
    const int ar = tid >> 2, ac = (tid & 3) * 8; const int gr = m0 + ar;
    const bf16_t* arow = nullptr;
    if (gr < Mrows) { const int row = rowidx ? (rowidx[gr] >> rshift) : gr; arow = A + (size_t)row * lda; }
    for (int k0 = 0; k0 < K; k0 += 32) {
        u32x4 v = (u32x4){0u, 0u, 0u, 0u};
        if (arow) v = *(const u32x4*)(arow + k0 + ac);
        As[(ac + 0) * 132 + ar] = bf2f(v.x & 0xffffu); As[(ac + 1) * 132 + ar] = bf2f(v.x >> 16);
        As[(ac + 2) * 132 + ar] = bf2f(v.y & 0xffffu); As[(ac + 3) * 132 + ar] = bf2f(v.y >> 16);
        As[(ac + 4) * 132 + ar] = bf2f(v.z & 0xffffu); As[(ac + 5) * 132 + ar] = bf2f(v.z >> 16);
        As[(ac + 6) * 132 + ar] = bf2f(v.w & 0xffffu); As[(ac + 7) * 132 + ar] = bf2f(v.w >> 16);
        if (tid < 256) { const u32x4 w = *(const u32x4*)(Bt + (size_t)(n0 + ar) * ldb + k0 + ac);
            Bs[(ac + 0) * 68 + ar] = bf2f(w.x & 0xffffu); Bs[(ac + 1) * 68 + ar] = bf2f(w.x >> 16);
            Bs[(ac + 2) * 68 + ar] = bf2f(w.y & 0xffffu); Bs[(ac + 3) * 68 + ar] = bf2f(w.y >> 16);
            Bs[(ac + 4) * 68 + ar] = bf2f(w.z & 0xffffu); Bs[(ac + 5) * 68 + ar] = bf2f(w.z >> 16);
            Bs[(ac + 6) * 68 + ar] = bf2f(w.w & 0xffffu); Bs[(ac + 7) * 68 + ar] = bf2f(w.w >> 16); }
        __syncthreads();
#pragma unroll 8
        for (int kk = 0; kk < 32; ++kk) {
            const f32x4 a = *(const f32x4*)(As + kk * 132 + ty * 4); const f32x4 b = *(const f32x4*)(Bs + kk * 68 + tx * 4);
#pragma unroll
            for (int i = 0; i < 4; ++i)
#pragma unroll
                for (int j = 0; j < 4; ++j) acc[i][j] = fmaf(a[i], b[j], acc[i][j]);
        }
        __syncthreads();
    }
#pragma unroll
    for (int i = 0; i < 4; ++i) { const int m = m0 + ty * 4 + i; if (m < Mrows) {
#pragma unroll
        for (int j = 0; j < 4; ++j) epi(m, n0 + tx * 4 + j, acc[i][j]); } }
}

__device__ __forceinline__ void p1_inproj(const Prm& p, unsigned char* lds, int wg, int nwg) {
    kmean_items(p, lds, wg, nwg);
    const bf16_t* XB = (const bf16_t*)p.out; const bf16_t* WIN = (const bf16_t*)(p.ws + WS_WIN); bf16_t* PROJ = (bf16_t*)(p.ws + WS_PROJ);
    constexpr int TN = INC / 64, NT = (M / 128) * TN;
    for (int it = wg; it < NT; it += nwg) { const int tm = it / TN, tn = it % TN;
        ngemm_tile(XB, D, nullptr, 0, M, tm * 128, WIN, D, tn * 64, D, lds, [&](int m, int n, float v) { PROJ[(size_t)m * INC + n] = (bf16_t)f2bf(v); }); }
}

__device__ __forceinline__ void p2_zpass(const Prm& p, int wg, int nwg) {
    bf16_t* PROJ = (bf16_t*)(p.ws + WS_PROJ);
    for (int it = wg * 512 + threadIdx.x; it < M * 64; it += nwg * 512) {
        const int row = it >> 6, c0 = (it & 63) * 8, t = row & (SEQ - 1);
        float u[3][8];
#pragma unroll
        for (int s = 0; s < 3; ++s) { const int tt = t - 2 + s;
            if (tt >= 0) { const bf16_t* r = PROJ + (size_t)(row - 2 + s) * INC; const u32x4 a = *(const u32x4*)(r + PC_CC + c0), b = *(const u32x4*)(r + PC_CX + c0);
#pragma unroll
                for (int i = 0; i < 4; ++i) { u[s][2 * i] = bf2f(a[i] & 0xffffu) * bf2f(b[i] & 0xffffu); u[s][2 * i + 1] = bf2f(a[i] >> 16) * bf2f(b[i] >> 16); } }
            else {
#pragma unroll
                for (int i = 0; i < 8; ++i) u[s][i] = 0.f; } }
        const u32x4 cb = *(const u32x4*)(PROJ + (size_t)row * INC + PC_CB + c0);
        float z[8];
#pragma unroll
        for (int i = 0; i < 8; ++i) { const float w0 = p.conv_w[c0 + i], w1 = p.conv_w[512 + c0 + i], w2 = p.conv_w[1024 + c0 + i];
            const float cbv = bf2f((i & 1) ? (cb[i >> 1] >> 16) : (cb[i >> 1] & 0xffffu));
            z[i] = cbv * (w0 * u[0][i] + w1 * u[1][i] + w2 * u[2][i]); }
        u32x4 o; o.x = pk2(z[0], z[1]); o.y = pk2(z[2], z[3]); o.z = pk2(z[4], z[5]); o.w = pk2(z[6], z[7]);
        *(u32x4*)(PROJ + (size_t)row * INC + PC_CB + c0) = o;
    }
}

__device__ __forceinline__ void p2_attn_naive(const Prm& p, int wg, int nwg) {
    bf16_t* PROJ = (bf16_t*)(p.ws + WS_PROJ); const float* KM = (const float*)(p.ws + WS_KMEAN);
    for (int item = wg * 512 + threadIdx.x; item < BATCH * NH * SEQ; item += nwg * 512) {
        const int t = item & (SEQ - 1), h = (item >> 11) & 7, b = item >> 14, qb = t >> 8;
        const size_t row = (size_t)b * SEQ + t;
        unsigned qp[32];
        { const u32x4* qq = (const u32x4*)(PROJ + row * INC + PC_Q + h * 64);
#pragma unroll
          for (int i = 0; i < 8; ++i) { const u32x4 v = qq[i]; qp[4 * i] = v.x; qp[4 * i + 1] = v.y; qp[4 * i + 2] = v.z; qp[4 * i + 3] = v.w; } }
        float g[7];
#pragma unroll
        for (int n = 0; n < 7; ++n) { g[n] = -INFINITY;
            if (n < qb) { const float* km = KM + (size_t)(b * NBLK + n) * 512 + h * 64; float s = 0.f;
#pragma unroll
                for (int d = 0; d < 32; ++d) { s = fmaf(bf2f(qp[d] & 0xffffu), km[2 * d], s); s = fmaf(bf2f(qp[d] >> 16), km[2 * d + 1], s); }
                g[n] = s; } }
        unsigned sel = 0;
#pragma unroll
        for (int n = 0; n < 7; ++n) { int rank = 0;
#pragma unroll
            for (int m2 = 0; m2 < 7; ++m2) if (m2 != n && m2 < qb) rank += (g[m2] > g[n] || (g[m2] == g[n] && m2 < n)) ? 1 : 0;
            if (n < qb && rank < 3) sel |= 1u << n; }
        const float a = exp2f(-(float)(h + 1)) * LOG2E;
        float mrun = -INFINITY, l = 0.f; float o[64];
#pragma unroll
        for (int d = 0; d < 64; ++d) o[d] = 0.f;
        for (int n = 0; n <= qb; ++n) {
            const bool blk_on = (n == qb) || ((sel >> n) & 1u);
            if (!__any(blk_on)) continue;
            for (int kk = 0; kk < MBLK; ++kk) {
                const int pos = n * MBLK + kk;
                const bool on = blk_on && (pos <= t);
                if (!__any(on)) continue;
                const bf16_t* kr = PROJ + ((size_t)b * SEQ + pos) * INC + PC_K + h * 64;
                float s = 0.f;
#pragma unroll
                for (int i = 0; i < 8; ++i) { const u32x4 v = ((const u32x4*)kr)[i];
#pragma unroll
                    for (int j = 0; j < 4; ++j) { s = fmaf(bf2f(qp[4 * i + j] & 0xffffu), bf2f(v[j] & 0xffffu), s); s = fmaf(bf2f(qp[4 * i + j] >> 16), bf2f(v[j] >> 16), s); } }
                s -= a * (float)(t - pos);
                if (on) {
                    const float mnew = fmaxf(mrun, s), corr = exp2f(mrun - mnew), pw = exp2f(s - mnew);
                    l = l * corr + pw; mrun = mnew;
                    const bf16_t* vr = kr + (PC_V - PC_K);
#pragma unroll
                    for (int i = 0; i < 8; ++i) { const u32x4 v = ((const u32x4*)vr)[i];
#pragma unroll
                        for (int j = 0; j < 4; ++j) { o[8 * i + 2 * j] = o[8 * i + 2 * j] * corr + pw * bf2f(v[j] & 0xffffu); o[8 * i + 2 * j + 1] = o[8 * i + 2 * j + 1] * corr + pw * bf2f(v[j] >> 16); } }
                }
            }
        }
        const float rl = 1.f / l;
        u32x4* op = (u32x4*)(PROJ + row * INC + PC_Q + h * 64);
#pragma unroll
        for (int i = 0; i < 8; ++i) { u32x4 w; w.x = pk2(o[8 * i] * rl, o[8 * i + 1] * rl); w.y = pk2(o[8 * i + 2] * rl, o[8 * i + 3] * rl); w.z = pk2(o[8 * i + 4] * rl, o[8 * i + 5] * rl); w.w = pk2(o[8 * i + 6] * rl, o[8 * i + 7] * rl); op[i] = w; }
    }
}

__device__ __forceinline__ void p3a_naive(const Prm& p, unsigned char* lds, int wg, int nwg) {
    bf16_t* PROJ = (bf16_t*)(p.ws + WS_PROJ); const bf16_t* WCAT = (const bf16_t*)(p.ws + WS_WCAT);
    constexpr int TN = D / 64, NT = (M / 128) * TN;
    for (int it = wg; it < NT; it += nwg) { const int tm = it / TN, tn = it % TN;
        ngemm_tile(PROJ + PC_CB, INC, nullptr, 0, M, tm * 128, WCAT, D, tn * 64, 512, lds, [&](int m, int n, float v) {
            bf16_t* yp = PROJ + (size_t)m * INC + PC_GA + n; *yp = (bf16_t)f2bf(sigmoidf_(bf2f(*yp)) * v); });
        ngemm_tile(PROJ + PC_Q, INC, nullptr, 0, M, tm * 128, WCAT + 512, D, tn * 64, 512, lds, [&](int m, int n, float v) {
            bf16_t* yp = PROJ + (size_t)m * INC + PC_GA + n; const float gb = bf2f(PROJ[(size_t)m * INC + PC_GB + n]); *yp = (bf16_t)f2bf(bf2f(*yp) + sigmoidf_(gb) * v); });
    }
}
__device__ __forceinline__ void p3b_naive(const Prm& p, unsigned char* lds, int wg, int nwg) {
    const bf16_t* PROJ = (const bf16_t*)(p.ws + WS_PROJ); const bf16_t* WO = (const bf16_t*)(p.ws + WS_WO);
    constexpr int TN = D / 64, NT = (M / 128) * TN;
    for (int it = wg; it < NT; it += nwg) { const int tm = it / TN, tn = it % TN;
        ngemm_tile(PROJ + PC_GA, INC, nullptr, 0, M, tm * 128, WO, D, tn * 64, D, lds, [&](int m, int n, float v) { p.out[(size_t)m * D + n] = ALPHA * p.x[(size_t)m * D + n] + v; }); }
}
__device__ __forceinline__ void p3c_ln_route(const Prm& p, int wg, int nwg) {
    const int tid = threadIdx.x, lane = tid & 63, wave = tid >> 6; const int gw = wg * 8 + wave, NGW = nwg * 8;
    bf16_t* X1B = (bf16_t*)(p.ws + WS_X1B); int* RE = (int*)(p.ws + WS_ROUTE); float* RG = (float*)(p.ws + WS_ROUTE + (size_t)M * 8);
    int* LIST = (int*)(p.ws + WS_LIST); unsigned* CNT = (unsigned*)(p.ws + WS_CTL) + CW_CNT;
    for (int m = gw; m < M; m += NGW) {
        f32x4* xr = (f32x4*)(p.out + (size_t)m * D) + lane;
        f32x4 v[4]; float s = 0.f;
#pragma unroll
        for (int j = 0; j < 4; ++j) { v[j] = xr[64 * j]; s += (v[j].x + v[j].y) + (v[j].z + v[j].w); }
        const float mean = wave_sum(s) * (1.f / D); float s2 = 0.f;
#pragma unroll
        for (int j = 0; j < 4; ++j) { v[j] = v[j] - mean; s2 += (v[j].x * v[j].x + v[j].y * v[j].y) + (v[j].z * v[j].z + v[j].w * v[j].w); }
        const float rstd = 1.f / sqrtf(wave_sum(s2) * (1.f / D) + LN_EPS);
        unsigned long long* o8 = (unsigned long long*)(X1B + (size_t)m * D) + lane;
#pragma unroll
        for (int j = 0; j < 4; ++j) { const f32x4 g = ((const f32x4*)p.ln1g)[64 * j + lane], bb = ((const f32x4*)p.ln1b)[64 * j + lane];
            v[j] = v[j] * rstd * g + bb; xr[64 * j] = v[j];
            o8[64 * j] = (unsigned long long)pk2(v[j].x, v[j].y) | ((unsigned long long)pk2(v[j].z, v[j].w) << 32); }
        float lg[4];
#pragma unroll
        for (int c = 0; c < 4; ++c) { float a = 0.f;
#pragma unroll
            for (int j = 0; j < 4; ++j) { const int k = 256 * j + 4 * lane; a += v[j].x * p.w_rg[(size_t)k * 4 + c] + v[j].y * p.w_rg[(size_t)(k + 1) * 4 + c] + v[j].z * p.w_rg[(size_t)(k + 2) * 4 + c] + v[j].w * p.w_rg[(size_t)(k + 3) * 4 + c]; }
            lg[c] = wave_sum(a); }
        int gt = 0; float gm = lg[0];
#pragma unroll
        for (int c = 1; c < 4; ++c) if (lg[c] > gm) { gm = lg[c]; gt = c; }
        float gs = 0.f;
#pragma unroll
        for (int c = 0; c < 4; ++c) gs += __expf(lg[c] - gm);
        const float gp = 1.f / gs;
        gt = __builtin_amdgcn_readfirstlane(gt);
        float l8[8];
#pragma unroll
        for (int c = 0; c < 8; ++c) { float a = 0.f; const float* wre = p.w_re + gt * 8 + c;
#pragma unroll
            for (int j = 0; j < 4; ++j) { const int k = 256 * j + 4 * lane; a += v[j].x * wre[(size_t)k * 32] + v[j].y * wre[(size_t)(k + 1) * 32] + v[j].z * wre[(size_t)(k + 2) * 32] + v[j].w * wre[(size_t)(k + 3) * 32]; }
            l8[c] = wave_sum(a); }
        int e0 = 0; float v0 = l8[0];
#pragma unroll
        for (int c = 1; c < 8; ++c) if (l8[c] > v0) { v0 = l8[c]; e0 = c; }
        int e1 = -1; float v1 = -INFINITY;
#pragma unroll
        for (int c = 0; c < 8; ++c) if (c != e0 && l8[c] > v1) { v1 = l8[c]; e1 = c; }
        const float ex = __expf(v1 - v0), w0 = gp / (1.f + ex), w1 = gp * ex / (1.f + ex);
        if (lane == 0) {
            const int E0 = gt * 8 + e0, E1 = gt * 8 + e1;
            RE[2 * m] = E0; RE[2 * m + 1] = E1; RG[2 * m] = w0; RG[2 * m + 1] = w1;
            const unsigned p0 = atomicAdd(CNT + E0, 1u); LIST[(size_t)E0 * M + p0] = 2 * m;
            const unsigned p1 = atomicAdd(CNT + E1, 1u); LIST[(size_t)E1 * M + p1] = 2 * m + 1;
        }
    }
}
__device__ __forceinline__ bool moe_item(const unsigned* CNT, int it, int tn_count, int& e, int& tm, int& tn, int& off, int& cnt) {
    int base = 0, o = 0;
    for (int ee = 0; ee < NE; ++ee) { const int c = (int)CNT[ee]; const int tiles = ((c + 127) >> 7) * tn_count;
        if (it < base + tiles) { const int r = it - base; e = ee; tm = r / tn_count; tn = r % tn_count; off = o; cnt = c; return true; }
        base += tiles; o += c; }
    return false;
}
__device__ __forceinline__ void p4a_gu(const Prm& p, unsigned char* lds, int wg, int nwg) {
    const unsigned* CNT = (const unsigned*)(p.ws + WS_CTL) + CW_CNT; const int* LIST = (const int*)(p.ws + WS_LIST);
    const bf16_t* X1B = (const bf16_t*)(p.ws + WS_X1B); const bf16_t* WGU = (const bf16_t*)(p.ws + WS_WGU); float* GU = (float*)(p.ws + WS_GU);
    for (int it = wg;; it += nwg) { int e, tm, tn, off, cnt; if (!moe_item(CNT, it, 8, e, tm, tn, off, cnt)) break;
        float* gu = GU + (size_t)off * 512;
        ngemm_tile(X1B, D, LIST + (size_t)e * M, 1, cnt, tm * 128, WGU + (size_t)e * 512 * D, D, tn * 64, D, lds, [&](int m, int n, float v) { gu[(size_t)m * 512 + n] = v; }); }
}
__device__ __forceinline__ void p4b_h(const Prm& p, int wg, int nwg) {
    const unsigned* CNT = (const unsigned*)(p.ws + WS_CTL) + CW_CNT; const int* LIST = (const int*)(p.ws + WS_LIST);
    const float* GU = (const float*)(p.ws + WS_GU); bf16_t* H = (bf16_t*)(p.ws + WS_H); const float* RG = (const float*)(p.ws + WS_ROUTE + (size_t)M * 8);
    int off = 0;
    for (int e = 0; e < NE; ++e) { const int cnt = (int)CNT[e];
        for (int i = wg * 512 + threadIdx.x; i < cnt * 256; i += nwg * 512) { const int m = i >> 8, f = i & 255, pn = f >> 7, j = f & 127;
            const float g = GU[(size_t)(off + m) * 512 + pn * 256 + j], u = GU[(size_t)(off + m) * 512 + pn * 256 + 128 + j];
            const float w = RG[LIST[(size_t)e * M + m]];
            H[(size_t)(off + m) * 256 + f] = (bf16_t)f2bf(g * sigmoidf_(g) * u * w); }
        off += cnt; }
}
__device__ __forceinline__ void p4c_down(const Prm& p, unsigned char* lds, int wg, int nwg) {
    const unsigned* CNT = (const unsigned*)(p.ws + WS_CTL) + CW_CNT; const int* LIST = (const int*)(p.ws + WS_LIST);
    const bf16_t* H = (const bf16_t*)(p.ws + WS_H); const bf16_t* WD = (const bf16_t*)(p.ws + WS_WD); bf16_t* C = (bf16_t*)(p.ws + WS_C);
    for (int it = wg;; it += nwg) { int e, tm, tn, off, cnt; if (!moe_item(CNT, it, 16, e, tm, tn, off, cnt)) break;
        const int* lst = LIST + (size_t)e * M;
        ngemm_tile(H + (size_t)off * 256, 256, nullptr, 0, cnt, tm * 128, WD + (size_t)e * D * DE, DE, tn * 64, DE, lds, [&](int m, int n, float v) { C[(size_t)lst[m] * D + n] = (bf16_t)f2bf(v); }); }
}
__device__ __forceinline__ void p5_final(const Prm& p, int wg, int nwg) {
    const int tid = threadIdx.x, lane = tid & 63, wave = tid >> 6; const int gw = wg * 8 + wave, NGW = nwg * 8;
    const bf16_t* C = (const bf16_t*)(p.ws + WS_C);
    for (int m = gw; m < M; m += NGW) {
        f32x4* xr = (f32x4*)(p.out + (size_t)m * D) + lane;
        const unsigned long long* c0 = (const unsigned long long*)(C + (size_t)(2 * m) * D) + lane; const unsigned long long* c1 = (const unsigned long long*)(C + (size_t)(2 * m + 1) * D) + lane;
        f32x4 v[4]; float s = 0.f;
#pragma unroll
        for (int j = 0; j < 4; ++j) { v[j] = xr[64 * j]; const unsigned long long a = c0[64 * j], b = c1[64 * j];
            v[j].x = ALPHA * v[j].x + (bf2f((unsigned)a & 0xffffu) + bf2f((unsigned)b & 0xffffu)); v[j].y = ALPHA * v[j].y + (bf2f(((unsigned)a) >> 16) + bf2f(((unsigned)b) >> 16));
            v[j].z = ALPHA * v[j].z + (bf2f((unsigned)(a >> 32) & 0xffffu) + bf2f((unsigned)(b >> 32) & 0xffffu)); v[j].w = ALPHA * v[j].w + (bf2f((unsigned)(a >> 48)) + bf2f((unsigned)(b >> 48)));
            s += (v[j].x + v[j].y) + (v[j].z + v[j].w); }
        const float mean = wave_sum(s) * (1.f / D); float s2 = 0.f;
#pragma unroll
        for (int j = 0; j < 4; ++j) { v[j] = v[j] - mean; s2 += (v[j].x * v[j].x + v[j].y * v[j].y) + (v[j].z * v[j].z + v[j].w * v[j].w); }
        const float rstd = 1.f / sqrtf(wave_sum(s2) * (1.f / D) + LN_EPS);
#pragma unroll
        for (int j = 0; j < 4; ++j) { const f32x4 g = ((const f32x4*)p.ln2g)[64 * j + lane], bb = ((const f32x4*)p.ln2b)[64 * j + lane]; xr[64 * j] = v[j] * rstd * g + bb; }
    }
}

#define LAS __attribute__((address_space(3)))
#define XB_TMO      128
#define XB_XCNT(j)  (256  + 64 * (j))
#define XB_XSUB(j)  (1280 + 64 * (j))
#define XB_XGEN(j)  (2304 + 64 * (j))
#define XB_TOP      3328
#define XB_TOPGEN   3392
#define XCD_BAR_WORDS 3456
#define XB_SPIN_CAP (1u << 20)
constexpr int CW_BAR = 4096;
__device__ __forceinline__ unsigned xb_ld(unsigned* p)              { return __hip_atomic_load(p, __ATOMIC_RELAXED, __HIP_MEMORY_SCOPE_AGENT); }
__device__ __forceinline__ unsigned xb_add(unsigned* p, unsigned v) { return __hip_atomic_fetch_add(p, v, __ATOMIC_RELAXED, __HIP_MEMORY_SCOPE_AGENT); }
__device__ __forceinline__ unsigned xb_xcc_id() { return (unsigned)__builtin_amdgcn_s_getreg((3 << 11) | 20) & 0xFu; }
#define XB_SPIN(cond, bar) do { unsigned _sp = 0; while (cond) { __builtin_amdgcn_s_sleep(1); \
    if ((++_sp & 255u) == 0u) { if (xb_ld(&(bar)[XB_TMO])) break; if (_sp > XB_SPIN_CAP) { atomicAdd(&(bar)[XB_TMO], 1u); break; } } } } while (0)
struct XcdBarrier { unsigned* bar; unsigned x; volatile LAS unsigned* st; };
__device__ __forceinline__ XcdBarrier xcd_barrier_post(unsigned* bar, volatile LAS unsigned* st) {
    XcdBarrier b; b.bar = bar; b.x = xb_xcc_id(); b.st = st;
    if (threadIdx.x == 0) (void)xb_add(&bar[XB_XCNT(b.x)], 1u);
    return b;
}
__device__ __forceinline__ void xcd_barrier_complete(unsigned* bar, unsigned x, unsigned& nloc, unsigned& nx) {
    const unsigned G = gridDim.x * gridDim.y * gridDim.z;
    unsigned sum, cnt, mine, sp = 0u;
    for (;;) {
        sum = 0u; cnt = 0u; mine = 0u;
#pragma unroll
        for (unsigned j = 0; j < 16; ++j) { const unsigned c = xb_ld(&bar[XB_XCNT(j)]); sum += c; cnt += (c > 0u) ? 1u : 0u; mine = (j == x) ? c : mine; }
        if (sum == G) break;
        __builtin_amdgcn_s_sleep(1);
        if ((++sp & 255u) == 0u) { if (xb_ld(&bar[XB_TMO])) break; if (sp > XB_SPIN_CAP) { atomicAdd(&bar[XB_TMO], 1u); break; } }
    }
    nloc = mine > 0u ? mine : 1u; nx = cnt > 0u ? cnt : 1u;
}
__device__ __forceinline__ void xcd_barrier(const XcdBarrier& b) {
    asm volatile("s_waitcnt vmcnt(0)" ::: "memory");
    __syncthreads();
    if (threadIdx.x == 0) {
        unsigned* bar = b.bar;
        __builtin_amdgcn_s_waitcnt(0);
        unsigned nloc = b.st[0], nx = b.st[1];
        if (nloc == 0u) { xcd_barrier_complete(bar, b.x, nloc, nx); b.st[0] = nloc; b.st[1] = nx; }
        const unsigned old = xb_add(&bar[XB_XSUB(b.x)], 1u);
        const unsigned gen = old / nloc;
        if (old + 1u == (gen + 1u) * nloc) {
            __builtin_amdgcn_fence(__ATOMIC_RELEASE, "agent");
            asm volatile("s_waitcnt vmcnt(0)" ::: "memory");
            const unsigned og = xb_add(&bar[XB_TOP], 1u);
            const unsigned tg = og / nx;
            if (og + 1u == (tg + 1u) * nx) xb_add(&bar[XB_TOPGEN], 1u);
            else XB_SPIN(xb_ld(&bar[XB_TOPGEN]) == tg, bar);
            __builtin_amdgcn_fence(__ATOMIC_ACQUIRE, "agent");
            xb_add(&bar[XB_XGEN(b.x)], 1u);
            asm volatile("s_waitcnt vmcnt(0)" ::: "memory");
        } else {
            XB_SPIN(xb_ld(&bar[XB_XGEN(b.x)]) == gen, bar);
            __builtin_amdgcn_fence(__ATOMIC_ACQUIRE, "agent");
            asm volatile("s_waitcnt vmcnt(0)" ::: "memory");
        }
    }
    __syncthreads();
}

constexpr int LDS_BYTES = 147456;
constexpr int MISC_OFF = 131072 + 320;
__global__ void __launch_bounds__(512, 2) mega_fwd(Prm p) {
    extern __shared__ __attribute__((aligned(16))) unsigned char lds[];
    const int wg = blockIdx.x, nwg = gridDim.x;
    for (int u = threadIdx.x; u < (LDS_BYTES - 131072) / 4; u += 512) ((LAS unsigned*)((LAS unsigned char*)lds + 131072))[u] = 0u;
    __syncthreads();
    unsigned* ctl = (unsigned*)(p.ws + WS_CTL);
    XcdBarrier bar = xcd_barrier_post(ctl + CW_BAR, (volatile LAS unsigned*)((LAS unsigned char*)lds + MISC_OFF) + 8);
    p0_prologue(p, lds, wg, nwg);                                   xcd_barrier(bar);
    p1_inproj(p, lds, wg, nwg);                                     xcd_barrier(bar);
    p2_zpass(p, wg, nwg); p2_attn_naive(p, wg, nwg);                xcd_barrier(bar);
    p3a_naive(p, lds, wg, nwg);                                     xcd_barrier(bar);
    p3b_naive(p, lds, wg, nwg);                                     xcd_barrier(bar);
    p3c_ln_route(p, wg, nwg);                                       xcd_barrier(bar);
    p4a_gu(p, lds, wg, nwg);                                        xcd_barrier(bar);
    p4b_h(p, wg, nwg);                                              xcd_barrier(bar);
    p4c_down(p, lds, wg, nwg);                                      xcd_barrier(bar);
    p5_final(p, wg, nwg);
}

extern "C" void kernel_launch(void* const* d_in, const int* in_sizes, int n_in, void* d_out, int out_size, void* d_ws, size_t ws_size, hipStream_t stream) {
    static int grid = 0;
    if (grid == 0) {
        if (n_in != 15 || out_size != M * D || ws_size < WS_END) { fprintf(stderr, "kernel_launch: unexpected shapes n_in %d out %d ws %zu\n", n_in, out_size, ws_size); grid = -1; return; }
        int dev = 0, cus = 0, per_cu = 0;
        if (hipGetDevice(&dev) != hipSuccess || hipDeviceGetAttribute(&cus, hipDeviceAttributeMultiprocessorCount, dev) != hipSuccess) { grid = -1; return; }
        if (hipFuncSetAttribute((const void*)mega_fwd, hipFuncAttributeMaxDynamicSharedMemorySize, LDS_BYTES) != hipSuccess) { grid = -1; return; }
        if (hipOccupancyMaxActiveBlocksPerMultiprocessor(&per_cu, (const void*)mega_fwd, 512, LDS_BYTES) != hipSuccess || per_cu < 1) { fprintf(stderr, "kernel_launch: occupancy query says %d\n", per_cu); per_cu = 1; }
        (void)hipGetLastError();
        grid = cus;
    }
    if (grid < 0) return;
    Prm p{};
    p.x = (const float*)d_in[0]; p.w_in = (const float*)d_in[1]; p.conv_w = (const float*)d_in[2]; p.w_oc = (const float*)d_in[3]; p.w_oa = (const float*)d_in[4];
    p.w_o = (const float*)d_in[5]; p.ln1g = (const float*)d_in[6]; p.ln1b = (const float*)d_in[7]; p.w_rg = (const float*)d_in[8]; p.w_re = (const float*)d_in[9];
    p.w_gate = (const float*)d_in[10]; p.w_up = (const float*)d_in[11]; p.w_down = (const float*)d_in[12]; p.ln2g = (const float*)d_in[13]; p.ln2b = (const float*)d_in[14];
    p.out = (float*)d_out; p.ws = (unsigned char*)d_ws;
    (void)hipMemsetAsync((char*)d_ws + WS_CTL, 0, CTL_BYTES, stream);
    hipLaunchKernelGGL(mega_fwd, dim3(grid), dim3(512), LDS_BYTES, stream, p);
}
```
